# Optimizing an MI355X kernel written in HIP

```python
import jax, jax.numpy as jnp
from jax import lax
import numpy as np

D_MODEL = 1024
BATCH = 1
SEQ = 16384
DEPTH = 4
DEC_BATCH = 2
DEC_SEQ = 8192
PAST_LEN = 128

N_HEADS = 4
HEAD_DIM = 128
MLSTM_WIDTH = N_HEADS * HEAD_DIM
CONV_WIDTH = D_MODEL - MLSTM_WIDTH
CONV_K = 3
CHUNK = 64
N_DIR = 2
N_GATE_COLS = N_DIR * 2 * N_HEADS
PROJ_WIDTH = 4 * MLSTM_WIDTH + N_GATE_COLS + 3 * CONV_WIDTH
D_FF = 4 * D_MODEL
ALPHA = (2.0 * DEPTH) ** 0.25
BETA = (8.0 * DEPTH) ** -0.25
LN_EPS = 1e-5

kernel_name = "hymba_mlstm_shortconv_deepnorm_encoder"

_SPLITS = list(np.cumsum([MLSTM_WIDTH, MLSTM_WIDTH, MLSTM_WIDTH, MLSTM_WIDTH,
                          N_GATE_COLS, CONV_WIDTH, CONV_WIDTH]))


def layer_norm(x, g, b):
    xf = x.astype(jnp.float32)
    mu = jnp.mean(xf, axis=-1, keepdims=True)
    xc = xf - mu
    var = jnp.mean(xc * xc, axis=-1, keepdims=True)
    y = xc * lax.rsqrt(var + LN_EPS) * g.astype(jnp.float32) + b.astype(jnp.float32)
    return y.astype(x.dtype)


def mlstm_chunkwise(q, k, v, ig, lf):
    n_b, n_h, s_len, dh = q.shape
    nc = s_len // CHUNK

    def to_chunks(t):
        t = t.reshape(n_b, n_h, nc, CHUNK, *t.shape[3:])
        return jnp.moveaxis(t, 2, 0)

    qc, kc, vc, ic = to_chunks(q), to_chunks(k), to_chunks(v), to_chunks(ig)
    bc = jnp.cumsum(to_chunks(lf), axis=-1)
    causal_in_scan = jnp.tril(jnp.ones((CHUNK, CHUNK), dtype=bool))

    def step(carry, inp):
        C, n, m = carry
        qt, kt, vt, it, bt = inp
        g = bt[..., -1]
        D = bt[..., :, None] - bt[..., None, :] + it[..., None, :]
        D = jnp.where(causal_in_scan, D, -jnp.inf)
        inter = bt + m[..., None]
        m_t = jnp.maximum(inter, jnp.max(D, axis=-1))
        wD = jnp.exp(D - m_t[..., None])
        w_inter = jnp.exp(inter - m_t)
        s = jnp.einsum('nhtd,nhsd->nhts', qt, kt) * wD
        num = (jnp.einsum('nhts,nhse->nhte', s, vt)
               + w_inter[..., None] * jnp.einsum('nhed,nhtd->nhte', C, qt))
        den = jnp.sum(s, axis=-1) + w_inter * jnp.einsum('nhd,nhtd->nht', n, qt)
        h = num / jnp.maximum(jnp.abs(den), jnp.exp(-m_t))[..., None]
        a = g[..., None] - bt + it
        m_new = jnp.maximum(g + m, jnp.max(a, axis=-1))
        wa = jnp.exp(a - m_new[..., None])
        wc = jnp.exp(g + m - m_new)
        C_new = wc[..., None, None] * C + jnp.einsum('nhs,nhse,nhsd->nhed', wa, vt, kt)
        n_new = wc[..., None] * n + jnp.einsum('nhs,nhsd->nhd', wa, kt)
        return (C_new, n_new, m_new), h

    init = (jnp.zeros((n_b, n_h, dh, dh), jnp.float32),
            jnp.zeros((n_b, n_h, dh), jnp.float32),
            jnp.zeros((n_b, n_h), jnp.float32))
    _, hs = lax.scan(step, init, (qc, kc, vc, ic, bc))
    return jnp.moveaxis(hs, 0, 2).reshape(n_b, n_h, s_len, dh)


def token_mixer(x, w_in, b_gate, mh_norm_w, conv_w, w_out):
    bsz, s_len, _ = x.shape
    proj = x @ w_in
    q, k, v, o, gates, cb, cc, ch = jnp.split(proj, _SPLITS, axis=-1)

    def heads(t):
        return t.reshape(bsz, s_len, N_HEADS, HEAD_DIM).transpose(0, 2, 1, 3).astype(jnp.float32)

    def both_dirs(t):
        return jnp.concatenate([t, jnp.flip(t, axis=2)], axis=0)

    gt = gates.astype(jnp.float32).reshape(bsz, s_len, N_DIR, 2, N_HEADS) + b_gate.astype(jnp.float32)
    gt = gt.transpose(2, 3, 0, 4, 1)
    ig = jnp.concatenate([gt[0, 0], jnp.flip(gt[1, 0], axis=-1)], axis=0)
    lf = jax.nn.log_sigmoid(jnp.concatenate([gt[0, 1], jnp.flip(gt[1, 1], axis=-1)], axis=0))
    qh = heads(q) * (HEAD_DIM ** -0.5)
    h = mlstm_chunkwise(both_dirs(qh), both_dirs(heads(k)), both_dirs(heads(v)), ig, lf)
    h = h[:bsz] + jnp.flip(h[bsz:], axis=2)
    mu = jnp.mean(h, axis=-1, keepdims=True)
    hc = h - mu
    h = hc * lax.rsqrt(jnp.mean(hc * hc, axis=-1, keepdims=True) + LN_EPS)
    h = h.transpose(0, 2, 1, 3).reshape(bsz, s_len, MLSTM_WIDTH) * mh_norm_w.astype(jnp.float32)
    h_m = (jax.nn.sigmoid(o.astype(jnp.float32)) * h).astype(x.dtype)

    u = cc * ch
    y = lax.conv_general_dilated(
        u, conv_w[:, None, :].astype(u.dtype), window_strides=(1,),
        padding=((CONV_K // 2, CONV_K // 2),),
        dimension_numbers=('NWC', 'WIO', 'NWC'),
        feature_group_count=CONV_WIDTH)
    h_c = cb * y

    return jnp.concatenate([h_m, h_c], axis=-1) @ w_out


def trunk(x, w_in, b_gate, mh_norm_w, conv_w, w_out, ln1_g, ln1_b, w_ff1, w_ff2, ln2_g, ln2_b):
    for l in range(DEPTH):
        mix = token_mixer(x, w_in[l], b_gate[l], mh_norm_w[l], conv_w[l], w_out[l])
        x = layer_norm(ALPHA * x + mix, ln1_g[l], ln1_b[l])
        ff = jnp.square(jax.nn.relu(x @ w_ff1[l])) @ w_ff2[l]
        x = layer_norm(ALPHA * x + ff, ln2_g[l], ln2_b[l])
    return x


def setup_inputs(seed: int = 0) -> dict:
    key = jax.random.key(seed)
    ks = jax.random.split(key, 16)
    f32 = jnp.float32
    x_prompt = jax.random.normal(ks[0], (BATCH, SEQ, D_MODEL), f32)
    x_sample = jax.random.normal(ks[1], (DEC_BATCH, DEC_SEQ, D_MODEL), f32)
    w_in = jax.random.normal(ks[2], (DEPTH, D_MODEL, PROJ_WIDTH), f32) * D_MODEL ** -0.5
    b_i = 0.1 * jax.random.normal(ks[3], (DEPTH, N_DIR, N_HEADS), f32)
    b_f = jnp.linspace(3.0, 6.0, N_HEADS, dtype=f32) + 0.1 * jax.random.normal(ks[4], (DEPTH, N_DIR, N_HEADS), f32)
    b_gate = jnp.stack([b_i, b_f], axis=2)
    mh_norm_w = 1.0 + 0.02 * jax.random.normal(ks[5], (DEPTH, MLSTM_WIDTH), f32)
    conv_w = jax.random.normal(ks[6], (DEPTH, CONV_K, CONV_WIDTH), f32) * CONV_K ** -0.5
    w_out = jax.random.normal(ks[7], (DEPTH, D_MODEL, D_MODEL), f32) * (D_MODEL ** -0.5 * BETA)
    ln1_g = 1.0 + 0.02 * jax.random.normal(ks[8], (DEPTH, D_MODEL), f32)
    ln1_b = 0.02 * jax.random.normal(ks[9], (DEPTH, D_MODEL), f32)
    w_ff1 = jax.random.normal(ks[10], (DEPTH, D_MODEL, D_FF), f32) * D_MODEL ** -0.5
    w_ff2 = jax.random.normal(ks[11], (DEPTH, D_FF, D_MODEL), f32) * (D_FF ** -0.5 * BETA)
    ln2_g = 1.0 + 0.02 * jax.random.normal(ks[12], (DEPTH, D_MODEL), f32)
    ln2_b = 0.02 * jax.random.normal(ks[13], (DEPTH, D_MODEL), f32)
    return {"x_prompt": x_prompt, "x_sample": x_sample, "w_in": w_in, "b_gate": b_gate,
            "mh_norm_w": mh_norm_w, "conv_w": conv_w, "w_out": w_out,
            "ln1_g": ln1_g, "ln1_b": ln1_b, "w_ff1": w_ff1, "w_ff2": w_ff2,
            "ln2_g": ln2_g, "ln2_b": ln2_b}


def reference(x_prompt, x_sample, w_in, b_gate, mh_norm_w, conv_w, w_out,
              ln1_g, ln1_b, w_ff1, w_ff2, ln2_g, ln2_b):
    y_prompt = trunk(x_prompt, w_in, b_gate, mh_norm_w, conv_w, w_out,
                     ln1_g, ln1_b, w_ff1, w_ff2, ln2_g, ln2_b)
    y_sample = trunk(x_sample, w_in, b_gate, mh_norm_w, conv_w, w_out,
                     ln1_g, ln1_b, w_ff1, w_ff2, ln2_g, ln2_b)
    return (y_prompt, y_sample)
```

```cpp
#include <hip/hip_runtime.h>
#include <hip/hip_cooperative_groups.h>
#include <cstdio>
#include <cstdint>
namespace cg = cooperative_groups;

#ifndef MK_COOP
#define MK_COOP 0
#endif

#ifdef ONLY_SUB
#define PH_ON(k) ((k) == ONLY_SUB)
#else
#define PH_ON(k) true
#endif
#define LAS __attribute__((address_space(3)))
typedef unsigned short bf16_t;
typedef short bf16x8 __attribute__((ext_vector_type(8)));
typedef short s16x4 __attribute__((ext_vector_type(4)));
typedef float f32x4 __attribute__((ext_vector_type(4)));
typedef float f32x16 __attribute__((ext_vector_type(16)));
typedef unsigned u32x4 __attribute__((ext_vector_type(4)));
typedef unsigned u32x2 __attribute__((ext_vector_type(2)));

__device__ __forceinline__ unsigned pk2(float lo, float hi) {
    typedef float f2 __attribute__((ext_vector_type(2))); typedef __bf16 b2 __attribute__((ext_vector_type(2)));
    f2 v = {lo, hi}; b2 b = __builtin_convertvector(v, b2); return __builtin_bit_cast(unsigned, b);
}
__device__ __forceinline__ float bflo(unsigned u) { return __uint_as_float(u << 16); }
__device__ __forceinline__ float bfhi(unsigned u) { return __uint_as_float(u & 0xffff0000u); }
__device__ __forceinline__ float bf2f(short s) { return __uint_as_float(((unsigned)(unsigned short)s) << 16); }
#define LDS_WAIT() asm volatile("s_waitcnt lgkmcnt(0)" ::: "memory")

namespace pg8 {
constexpr int BM = 256, BK = 64, HALF = 128, HTB = HALF * BK * 2, STAGE_BYTES = 8 * HTB, NXCD = 8, WGM = 8;
__host__ __device__ __forceinline__ int lds_byte(int r, int c) { const int st = (r >> 4) * 2 + (c >> 5), rr = r & 15, cc = c & 31, ob = rr * 64 + cc * 2; return st * 1024 + (ob ^ (((ob >> 9) & 1) << 5)); }
__host__ __device__ __forceinline__ void stage_rc(int b, int& R, int& C) { const int st = b / 1024, sb = b % 1024, swz = sb ^ (((sb >> 9) & 1) << 5); R = (st >> 1) * 16 + swz / 64; C = (st & 1) * 32 + (swz % 64) / 2; }
__host__ __device__ __forceinline__ int perm32(int rho) { const int n = rho >> 4, i = rho & 15; return 8 * (i >> 2) + 4 * n + (i & 3); }

struct Unit { int pm, pn; };
struct Gemm { const bf16_t* A; const bf16_t* Bt; int M, N, K, lda; };

struct StaticOrder {
    int nM, nN, nwg, G, c;
    __host__ __device__ void init(int M, int N, int G_, int c_) { nM = M / BM; nN = N / BM; nwg = nM * nN; G = G_; c = c_; }
    __host__ __device__ bool next(int i, Unit& u) const {
        const long L = (long)i * G + c; if (L >= nwg) return false;
        int wgid = (int)L; { const int q = nwg / NXCD, r = nwg % NXCD, xcd = wgid % NXCD, off = wgid / NXCD; wgid = (xcd < r ? xcd * (q + 1) : r * (q + 1) + (xcd - r) * q) + off; }
        const int nig = WGM * nN, gid = wgid / nig, fm = gid * WGM, gsz = (nM - fm) < WGM ? (nM - fm) : WGM;
        u.pm = fm + ((wgid % nig) % gsz); u.pn = (wgid % nig) / gsz; return true;
    }
};

__device__ __forceinline__ unsigned cvt_pk_bf16(float lo, float hi) { unsigned r; asm volatile("v_cvt_pk_bf16_f32 %0, %1, %2" : "=v"(r) : "v"(lo), "v"(hi)); return r; }

template <int ACT> struct EpiBf16 {
    static constexpr bool PERM = true;
    bf16_t* O; int ldc;
    __device__ __forceinline__ void operator()(const f32x4 (&acc)[2][2][4][2], const Unit& u, int wr, int wc, int fr, int fq) const {
        const int row0 = u.pm * BM + wr * 64 + fr; const int col0 = u.pn * BM + wc * 32 + 8 * fq;
#pragma unroll
        for (int ai = 0; ai < 2; ++ai)
#pragma unroll
            for (int m = 0; m < 4; ++m) { bf16_t* rowp = O + (size_t)(row0 + ai * HALF + m * 16) * ldc + col0;
#pragma unroll
                for (int bj = 0; bj < 2; ++bj) { f32x4 v0 = acc[ai][bj][m][0], v1 = acc[ai][bj][m][1];
                    if (ACT == 2) {
#pragma unroll
                        for (int e = 0; e < 4; ++e) { float a = v0[e] > 0.f ? v0[e] : 0.f; v0[e] = a * a; float b = v1[e] > 0.f ? v1[e] : 0.f; v1[e] = b * b; } }
                    u32x4 w; w.x = cvt_pk_bf16(v0[0], v0[1]); w.y = cvt_pk_bf16(v0[2], v0[3]); w.z = cvt_pk_bf16(v1[0], v1[1]); w.w = cvt_pk_bf16(v1[2], v1[3]);
                    *(u32x4*)(rowp + bj * HALF) = w; } }
    }
};
struct EpiRes {
    static constexpr bool PERM = false;
    const float* base; float* out; int ldc; float alpha;
    __device__ __forceinline__ void operator()(const f32x4 (&acc)[2][2][4][2], const Unit& u, int wr, int wc, int fr, int fq) const {
        const int row0 = u.pm * BM + wr * 64 + fr, col0 = u.pn * BM + wc * 32 + 4 * fq;
#pragma unroll
        for (int ai = 0; ai < 2; ++ai)
#pragma unroll
            for (int m = 0; m < 4; ++m) { const size_t off = (size_t)(row0 + ai * HALF + m * 16) * ldc + col0;
#pragma unroll
                for (int bj = 0; bj < 2; ++bj)
#pragma unroll
                    for (int n = 0; n < 2; ++n) { const size_t p = off + bj * HALF + n * 16; const f32x4 b = *(const f32x4*)(base + p); *(f32x4*)(out + p) = b * alpha + acc[ai][bj][m][n]; } }
    }
};

template <class Epi, bool ALIGN_EPI>
__device__ __forceinline__ void gemm_phase(LAS unsigned char* lds, const Gemm g, const StaticOrder& S, const Epi& E, const int tid) {
    const int wid = __builtin_amdgcn_readfirstlane(tid >> 6), lane = tid & 63, wr = wid >> 2, wc = wid & 3, fr = lane & 15, fq = lane >> 4;
    const int K = g.K, nt = K / BK;
    unsigned voffA[2], voffB[2];
#pragma unroll
    for (int i = 0; i < 2; ++i) { int R, C; stage_rc(tid * 16 + i * 8192, R, C); const int Rb = Epi::PERM ? ((R & ~31) + perm32(R & 31)) : R;
        voffA[i] = (unsigned)(R * g.lda + C) * 2u; voffB[i] = (unsigned)(Rb * K + C) * 2u; }
    const size_t kstep = (size_t)(BK * 2);
    const size_t hstepA = (size_t)HALF * g.lda * 2, hstepB = (size_t)HALF * K * 2;
    const size_t tstepA = 2 * hstepA, tstepB = 2 * hstepB;
    const unsigned ldsw = (unsigned)wid * 1024u;
    const int aoff = lds_byte(wr * 64 + fr, fq * 8), boff = lds_byte(wc * 32 + fr, fq * 8);
#define PG8_SA(b, h) (((b) * 2 + (h)) * HTB)
#define PG8_SB(b, h) ((4 + (b) * 2 + (h)) * HTB)
#define PG8_STAGE(bufoff, gbase, voff) do { _Pragma("unroll") for (int _i = 0; _i < 2; ++_i) \
        __builtin_amdgcn_global_load_lds((const unsigned*)((const char*)(gbase) + (voff)[_i]), (LAS unsigned*)(lds + (bufoff) + ldsw + _i * 8192), 16, 0, 0); } while (0)
#define PG8_LDA(dst, b, h) do { _Pragma("unroll") for (int m = 0; m < 4; ++m) _Pragma("unroll") for (int k = 0; k < 2; ++k) dst[m][k] = *(const LAS bf16x8*)(lds + PG8_SA(b, h) + aoff + m * 2048 + k * 1024); } while (0)
#define PG8_LDB(dst, b, h) do { _Pragma("unroll") for (int n = 0; n < 2; ++n) _Pragma("unroll") for (int k = 0; k < 2; ++k) dst[n][k] = *(const LAS bf16x8*)(lds + PG8_SB(b, h) + boff + n * 2048 + k * 1024); } while (0)
#define PG8_MMA(ai, bj, At, Bt) do { __builtin_amdgcn_s_setprio(1); _Pragma("unroll") for (int m = 0; m < 4; ++m) _Pragma("unroll") for (int n = 0; n < 2; ++n) _Pragma("unroll") for (int k = 0; k < 2; ++k) \
        acc[ai][bj][m][n] = __builtin_amdgcn_mfma_f32_16x16x32_bf16(Bt[n][k], At[m][k], acc[ai][bj][m][n], 0, 0, 0); __builtin_amdgcn_s_setprio(0); } while (0)
#define PG8_WAIT_V(n) asm volatile("s_waitcnt vmcnt(" #n ")" ::: "memory")
#define PG8_WAIT_L(n) asm volatile("s_waitcnt lgkmcnt(" #n ")" ::: "memory")
#define PG8_BAR __builtin_amdgcn_s_barrier()
#define PG8_SCHED __builtin_amdgcn_sched_barrier(0)
    Unit cur, nxt; int ui = 0;
    if (!S.next(0, cur)) return;
    f32x4 acc[2][2][4][2];
#pragma unroll
    for (int a = 0; a < 2; ++a)
#pragma unroll
        for (int b = 0; b < 2; ++b)
#pragma unroll
            for (int m = 0; m < 4; ++m)
#pragma unroll
                for (int n = 0; n < 2; ++n) acc[a][b][m][n] = (f32x4){0.f, 0.f, 0.f, 0.f};
    bf16x8 At[4][2], B0[2][2], B1[2][2];
    const char* cA = (const char*)g.A + (size_t)cur.pm * tstepA; const char* cB = (const char*)g.Bt + (size_t)cur.pn * tstepB;
    PG8_STAGE(PG8_SB(0, 0), cB, voffB); PG8_STAGE(PG8_SB(0, 1), cB + hstepB, voffB); PG8_STAGE(PG8_SA(0, 0), cA, voffA); PG8_STAGE(PG8_SA(0, 1), cA + hstepA, voffA);
    if (wr == 1) PG8_BAR;
    PG8_WAIT_V(2); PG8_BAR;
    PG8_STAGE(PG8_SB(1, 0), cB + kstep, voffB); PG8_STAGE(PG8_SA(1, 0), cA + kstep, voffA); PG8_STAGE(PG8_SB(1, 1), cB + hstepB + kstep, voffB);
    PG8_WAIT_V(6); PG8_BAR;
    for (;;) {
        const bool has_next = S.next(ui + 1, nxt);
        const char* nA = has_next ? (const char*)g.A + (size_t)nxt.pm * tstepA : cA; const char* nB = has_next ? (const char*)g.Bt + (size_t)nxt.pn * tstepB : cB;
        for (int t = 0; t < nt; t += 2) {
            const bool last = (t == nt - 2);
            const char* a1 = cA + (size_t)(t + 1) * kstep;
            const char* a2 = last ? nA : cA + (size_t)(t + 2) * kstep; const char* b2 = last ? nB : cB + (size_t)(t + 2) * kstep;
            const char* a3 = a2 + kstep; const char* b3 = b2 + kstep;
            PG8_LDB(B0, 0, 0); PG8_LDB(B1, 0, 1); PG8_SCHED; PG8_LDA(At, 0, 0); PG8_STAGE(PG8_SA(1, 1), a1 + hstepA, voffA);
            PG8_WAIT_V(8); PG8_WAIT_L(0); PG8_BAR; PG8_MMA(0, 0, At, B0); PG8_MMA(0, 1, At, B1); PG8_BAR; PG8_SCHED;
            PG8_LDA(At, 0, 1); PG8_STAGE(PG8_SB(0, 0), b2, voffB); PG8_STAGE(PG8_SB(0, 1), b2 + hstepB, voffB); PG8_STAGE(PG8_SA(0, 0), a2, voffA);
            PG8_WAIT_V(8); PG8_WAIT_L(0); PG8_BAR; PG8_MMA(1, 0, At, B0); PG8_MMA(1, 1, At, B1); PG8_BAR; PG8_SCHED;
            PG8_LDB(B0, 1, 0); PG8_LDB(B1, 1, 1); PG8_SCHED; PG8_LDA(At, 1, 0); PG8_STAGE(PG8_SA(0, 1), a2 + hstepA, voffA);
            PG8_WAIT_V(8); PG8_WAIT_L(0); PG8_BAR; PG8_MMA(0, 0, At, B0); PG8_MMA(0, 1, At, B1); PG8_BAR; PG8_SCHED;
            PG8_LDA(At, 1, 1); PG8_STAGE(PG8_SB(1, 0), b3, voffB); PG8_STAGE(PG8_SB(1, 1), b3 + hstepB, voffB); PG8_STAGE(PG8_SA(1, 0), a3, voffA);
            PG8_WAIT_V(8); PG8_WAIT_L(0); PG8_BAR; PG8_MMA(1, 0, At, B0); PG8_MMA(1, 1, At, B1); PG8_BAR; PG8_SCHED;
        }
        if constexpr (ALIGN_EPI) { if (wr == 0) PG8_BAR; }
        E(acc, cur, wr, wc, fr, fq);
        if (!has_next) break;
#pragma unroll
        for (int a = 0; a < 2; ++a)
#pragma unroll
            for (int b = 0; b < 2; ++b)
#pragma unroll
                for (int m = 0; m < 4; ++m)
#pragma unroll
                    for (int n = 0; n < 2; ++n) acc[a][b][m][n] = (f32x4){0.f, 0.f, 0.f, 0.f};
        cur = nxt; cA = nA; cB = nB; ++ui;
        if constexpr (ALIGN_EPI) { if (wr == 1) PG8_BAR; }
    }
    PG8_WAIT_V(0);
    if constexpr (!ALIGN_EPI) { if (wr == 0) PG8_BAR; }
    PG8_BAR;
#undef PG8_SA
#undef PG8_SB
#undef PG8_STAGE
#undef PG8_LDA
#undef PG8_LDB
#undef PG8_MMA
#undef PG8_WAIT_V
#undef PG8_WAIT_L
#undef PG8_BAR
#undef PG8_SCHED
}
}

constexpr int D = 1024, FF = 4096, DEPTH = 4, MTOK = 32768, MHALF = 16384, PW = 2048, WIN_N = 3600;
constexpr float ALPHA = 1.6817928305074290f;
constexpr float LN_EPS = 1e-5f;
constexpr float QSCALE = 0.08838834764831845f;
constexpr int NPH_LAYER = 13, NPHASES = 1 + DEPTH * NPH_LAYER;
constexpr int NWAVES = 8, NTHREADS = 512;
constexpr int LDS_BYTES = 147456;

constexpr size_t W_IN_B = (size_t)3584 * 1024 * 2, W_OUT_B = (size_t)1024 * 1024 * 2, W_FF1_B = (size_t)4096 * 1024 * 2, W_FF2_B = W_FF1_B;
constexpr size_t W_LAYER_B = W_IN_B + W_OUT_B + W_FF1_B + W_FF2_B;
constexpr size_t WS_W = 65536;
constexpr size_t WS_XB = WS_W + DEPTH * W_LAYER_B;
constexpr size_t WS_G = WS_XB + (size_t)MTOK * D * 2;
constexpr size_t WS_PROJ = WS_G + (size_t)MTOK * 16 * 4;
constexpr size_t WS_S = WS_PROJ + (size_t)MTOK * PW * 2;
constexpr size_t WS_NS = WS_S + (size_t)1024 * 32768;
constexpr size_t WS_GS = WS_NS + (size_t)1024 * 128 * 4;
constexpr size_t WS_END = WS_GS + 4096;
static_assert((size_t)MHALF * FF * 2 <= WS_S - WS_PROJ, "HID half overlays PROJ");

constexpr int KI_PITCH = 136, VT_PITCH = 264;
constexpr int L_KI = 0, L_VT = 69632, L_BT = L_VT + 67584, L_CS = L_BT + 2048, L_NST = L_CS + 2048, L_MISC = L_NST + 1024;
static_assert(L_MISC + 128 <= LDS_BYTES, "lds map");
static_assert(128 * VT_PITCH * 2 <= L_VT, "KsT image fits in the K image region");

struct Args { const float* in[13]; float* out; unsigned char* ws; int ph_lo, ph_hi; };

__device__ __forceinline__ float wave_sum(float v) {
#pragma unroll
    for (int o = 1; o < 64; o <<= 1) v += __shfl_xor(v, o);
    return v;
}

__device__ __forceinline__ void transpose_item(const float* W, int ldw, int src_col0, int K, bf16_t* WT, int dst_row0, float scale, LAS float* scr, int kb, int nb, int lane) {
    const int k0 = 64 * kb, n0 = 32 * nb;
#pragma unroll 8
    for (int i = 0; i < 32; ++i) { const int kk = 2 * i + (lane >> 5); scr[kk * 33 + (lane & 31)] = W[(size_t)(k0 + kk) * ldw + src_col0 + n0 + (lane & 31)] * scale; }
    LDS_WAIT(); asm volatile("" ::: "memory");
    const int c = lane & 7;
#pragma unroll
    for (int j = 0; j < 4; ++j) { const int n = (lane >> 3) + 8 * j; const LAS float* s = scr + (8 * c) * 33 + n;
        u32x4 o; o.x = pk2(s[0 * 33], s[1 * 33]); o.y = pk2(s[2 * 33], s[3 * 33]); o.z = pk2(s[4 * 33], s[5 * 33]); o.w = pk2(s[6 * 33], s[7 * 33]);
        *(u32x4*)(WT + (size_t)(dst_row0 + n0 + n) * K + k0 + 8 * c) = o; }
    LDS_WAIT(); asm volatile("" ::: "memory");
}

__device__ __forceinline__ void gates_prepare(LAS unsigned char* lds, const float* G, int tok0, int head, int tid, int wave, int lane) {
    LAS float* bt = (LAS float*)(lds + L_BT); LAS float* cs = (LAS float*)(lds + L_CS); LAS float* misc = (LAS float*)(lds + L_MISC);
    const int dir = tid >> 8, t = tid & 255;
    const float* grow = G + (size_t)(tok0 + t) * 16 + dir * 8 + head;
    const float ig = grow[0], fg = grow[4];
    const float lf = fminf(fg, 0.f) - log1pf(__expf(-fabsf(fg)));
    float c = lf;
#pragma unroll
    for (int o = 1; o < 64; o <<= 1) { const float u = __shfl_up(c, o); if (lane >= o) c += u; }
    if (lane == 63) misc[wave] = c;
    __syncthreads();
    const int wb = wave & 4; float pre = 0.f;
    const float t0 = misc[wb], t1 = misc[wb + 1], t2 = misc[wb + 2], t3 = misc[wb + 3];
    const int w4 = wave & 3;
    if (w4 > 0) pre += t0; if (w4 > 1) pre += t1; if (w4 > 2) pre += t2;
    const float T = (t0 + t1) + (t2 + t3);
    c += pre;
    const float b = dir == 0 ? c : T - (c - lf);
    bt[dir * 256 + t] = b; cs[dir * 256 + t] = ig - b;
    if (t == 0) misc[8 + dir] = T;
    __syncthreads();
}

__device__ __forceinline__ int crow(int reg, int h) { return (reg & 3) + 8 * (reg >> 2) + 4 * h; }
#define MFMA32(a, b, c) __builtin_amdgcn_mfma_f32_32x32x16_bf16((a), (b), (c), 0, 0, 0)

__global__ void __launch_bounds__(NTHREADS, 2) mk_fwd(Args args) {
    extern __shared__ __attribute__((aligned(16))) unsigned char lds_raw[];
    LAS unsigned char* lds = (LAS unsigned char*)lds_raw;
    cg::grid_group grid = cg::this_grid();
    const int G_ = gridDim.x, bx = blockIdx.x, NGW = G_ * NWAVES;
    unsigned char* ws0 = args.ws;
    const float* x_prompt = args.in[0]; const float* x_sample = args.in[1]; const float* w_in = args.in[2]; const float* b_gate = args.in[3];
    const float* mh_norm_w = args.in[4]; const float* conv_w = args.in[5]; const float* w_out = args.in[6];
    const float* ln1_g = args.in[7]; const float* ln1_b = args.in[8]; const float* w_ff1 = args.in[9]; const float* w_ff2 = args.in[10];
    const float* ln2_g = args.in[11]; const float* ln2_b = args.in[12];
    float* X0 = args.out;

    for (int ph = args.ph_lo; ph < args.ph_hi; ++ph) {
        unsigned char* ws = ws0; float* X = X0;
        int tid = threadIdx.x;
        asm volatile("" : "+s"(ws), "+s"(X), "+v"(tid));
        const int lane = tid & 63, wave = __builtin_amdgcn_readfirstlane(tid >> 6), gw = bx * NWAVES + wave;
        bf16_t* XB = (bf16_t*)(ws + WS_XB); float* GT = (float*)(ws + WS_G); bf16_t* PROJ = (bf16_t*)(ws + WS_PROJ);
        bf16_t* SB = (bf16_t*)(ws + WS_S); float* NS = (float*)(ws + WS_NS); float* GS = (float*)(ws + WS_GS);
        bf16_t* HID = (bf16_t*)(ws + WS_PROJ);
        if (PH_ON(99) && ph == 0) {
            LAS float* scr = (LAS float*)(lds + wave * 16384);
            for (int it = gw; it < DEPTH * 6400; it += NGW) {
                const int l = it / 6400; int r = it % 6400;
                bf16_t* wl = (bf16_t*)(ws + WS_W + (unsigned)(l * (int)W_LAYER_B));
                if (r < 1792) { const int seg = r >> 8, rr = r & 255; const int src = seg == 0 ? 1536 : (seg < 4 ? (seg - 1) * 512 : 2064 + (seg - 4) * 512);
                    transpose_item(w_in + (size_t)l * D * WIN_N, WIN_N, src, D, wl, 512 * seg, seg == 1 ? QSCALE : 1.f, scr, rr >> 4, rr & 15, lane); continue; }
                r -= 1792;
                if (r < 512) { transpose_item(w_out + (size_t)l * D * D, D, 0, D, wl + W_IN_B / 2, 0, 1.f, scr, r >> 5, r & 31, lane); continue; }
                r -= 512;
                if (r < 2048) { transpose_item(w_ff1 + (size_t)l * D * FF, FF, 0, D, wl + (W_IN_B + W_OUT_B) / 2, 0, 1.f, scr, r >> 7, r & 127, lane); continue; }
                r -= 2048;
                transpose_item(w_ff2 + (size_t)l * FF * D, D, 0, FF, wl + (W_IN_B + W_OUT_B + W_FF1_B) / 2, 0, 1.f, scr, r >> 5, r & 31, lane);
            }
            for (int m = gw; m < MTOK; m += NGW) {
                const float* src = m < MHALF ? x_prompt + (size_t)m * D : x_sample + (size_t)(m - MHALF) * D;
                const f32x4* xr = (const f32x4*)src + lane; f32x4* o4 = (f32x4*)(X + (size_t)m * D) + lane; u32x2* o2 = (u32x2*)(XB + (size_t)m * D) + lane;
#pragma unroll
                for (int j = 0; j < 4; ++j) { const f32x4 v = xr[64 * j]; o4[64 * j] = v; u32x2 w; w.x = pk2(v[0], v[1]); w.y = pk2(v[2], v[3]); o2[64 * j] = w; }
            }
        } else {
            const int l = (ph - 1) / NPH_LAYER, sub = (ph - 1) % NPH_LAYER;
#define WL_PTR(off) ((const bf16_t*)(ws + (WS_W + (off)) + (unsigned)(l * (int)W_LAYER_B)))
            if (PH_ON(0) && (sub == 0 || sub == 4)) {
                const bool a2 = sub == 4;
                const bf16_t* Win_t = WL_PTR(0);
                pg8::Gemm g{XB, a2 ? Win_t + (size_t)2048 * D : Win_t, MTOK, a2 ? 1536 : 2048, D, D};
                pg8::StaticOrder S; S.init(MTOK, g.N, G_, bx);
                pg8::EpiBf16<0> E{a2 ? PROJ + 512 : PROJ, PW};
                pg8::gemm_phase<pg8::EpiBf16<0>, true>(lds, g, S, E, tid);
                if (!a2) {
                    __syncthreads();
                    const float* wg = w_in + (size_t)l * D * WIN_N + 2048;
#pragma unroll
                    for (int i = 0; i < 8; ++i) { const int idx = tid + 512 * i, k = idx >> 2, j4 = idx & 3;
                        const f32x4 w = *(const f32x4*)(wg + (size_t)k * WIN_N + 4 * j4); *(LAS f32x4*)(lds + (k * 16 + 4 * j4) * 4) = w; }
                    __syncthreads();
                    const float bg = b_gate[l * 16 + (lane & 15)];
                    for (int m0 = gw * 4; m0 < MTOK; m0 += NGW * 4) {
                        float v[64];
#pragma unroll
                        for (int q = 0; q < 64; ++q) v[q] = 0.f;
                        const float* xr = X + (size_t)m0 * D + lane;
#pragma unroll 4
                        for (int i = 0; i < 16; ++i) {
                            const int k = lane + 64 * i;
                            const LAS f32x4* wp = (const LAS f32x4*)(lds + k * 64);
                            const f32x4 w0 = wp[0], w1 = wp[1], w2 = wp[2], w3 = wp[3];
#pragma unroll
                            for (int tt = 0; tt < 4; ++tt) { const float xv = xr[(size_t)tt * D + 64 * i];
#pragma unroll
                                for (int e = 0; e < 4; ++e) { v[tt * 16 + e] += xv * w0[e]; v[tt * 16 + 4 + e] += xv * w1[e]; v[tt * 16 + 8 + e] += xv * w2[e]; v[tt * 16 + 12 + e] += xv * w3[e]; } }
                        }
#pragma unroll
                        for (int i = 0; i < 32; ++i) { const bool up = (lane & 32) != 0; const float snd = up ? v[i] : v[i + 32], kp = up ? v[i + 32] : v[i]; v[i] = kp + __shfl_xor(snd, 32); }
#pragma unroll
                        for (int i = 0; i < 16; ++i) { const bool up = (lane & 16) != 0; const float snd = up ? v[i] : v[i + 16], kp = up ? v[i + 16] : v[i]; v[i] = kp + __shfl_xor(snd, 16); }
#pragma unroll
                        for (int i = 0; i < 8; ++i) { const bool up = (lane & 8) != 0; const float snd = up ? v[i] : v[i + 8], kp = up ? v[i + 8] : v[i]; v[i] = kp + __shfl_xor(snd, 8); }
#pragma unroll
                        for (int i = 0; i < 4; ++i) { const bool up = (lane & 4) != 0; const float snd = up ? v[i] : v[i + 4], kp = up ? v[i + 4] : v[i]; v[i] = kp + __shfl_xor(snd, 4); }
#pragma unroll
                        for (int i = 0; i < 2; ++i) { const bool up = (lane & 2) != 0; const float snd = up ? v[i] : v[i + 2], kp = up ? v[i + 2] : v[i]; v[i] = kp + __shfl_xor(snd, 2); }
                        { const bool up = (lane & 1) != 0; const float snd = up ? v[0] : v[1], kp = up ? v[1] : v[0]; v[0] = kp + __shfl_xor(snd, 1); }
                        GT[(size_t)m0 * 16 + lane] = v[0] + bg;
                    }
                    __syncthreads();
                }
            } else if (PH_ON(1) && sub == 1) {
                LAS bf16_t* KsT = (LAS bf16_t*)(lds + L_KI); LAS bf16_t* VT = (LAS bf16_t*)(lds + L_VT);
                LAS float* cs = (LAS float*)(lds + L_CS); LAS float* misc = (LAS float*)(lds + L_MISC);
                const int r = lane & 31, h = lane >> 5;
                for (int item = bx; item < 512; item += G_) {
                    const int cgk = item >> 2, head = item & 3, tok0 = cgk * 256;
                    int tl = tid; asm volatile("" : "+v"(tl));
                    __syncthreads();
#pragma unroll
                    for (int i = 0; i < 8; ++i) { const int idx = tl + 512 * i, s = idx & 255, gd = idx >> 8;
                        const bf16x8 v = *(const bf16x8*)(PROJ + (size_t)(tok0 + s) * PW + 1536 + head * 128 + 8 * gd);
#pragma unroll
                        for (int j = 0; j < 8; ++j) VT[(8 * gd + j) * VT_PITCH + s] = (bf16_t)v[j]; }
                    gates_prepare(lds, GT, tok0, head, tid, wave, lane);
                    for (int dir = 0; dir < 2; ++dir) {
                        const float T = misc[8 + dir];
#pragma unroll
                        for (int i = 0; i < 8; ++i) { const int idx = tl + 512 * i, s = idx & 255, gd = idx >> 8;
                            const bf16x8 v = *(const bf16x8*)(PROJ + (size_t)(tok0 + s) * PW + 1024 + head * 128 + 8 * gd);
                            const float wa = __expf(T + cs[dir * 256 + s]);
#pragma unroll
                            for (int j = 0; j < 8; ++j) KsT[(8 * gd + j) * VT_PITCH + s] = (bf16_t)(pk2(wa * bf2f(v[j]), 0.f) & 0xffffu); }
                        __syncthreads();
                        const int et = wave >> 1, dtb = (wave & 1) * 2;
                        f32x16 acc0, acc1;
#pragma unroll
                        for (int q = 0; q < 16; ++q) { acc0[q] = 0.f; acc1[q] = 0.f; }
#pragma unroll 4
                        for (int ks = 0; ks < 16; ++ks) {
                            const bf16x8 a = *(const LAS bf16x8*)(VT + (32 * et + r) * VT_PITCH + 16 * ks + 8 * h);
                            const bf16x8 b0 = *(const LAS bf16x8*)(KsT + (32 * dtb + r) * VT_PITCH + 16 * ks + 8 * h);
                            const bf16x8 b1 = *(const LAS bf16x8*)(KsT + (32 * (dtb + 1) + r) * VT_PITCH + 16 * ks + 8 * h);
                            acc0 = MFMA32(a, b0, acc0); acc1 = MFMA32(a, b1, acc1);
                        }
                        const int idxs = (cgk * 4 + head) * 2 + dir;
                        bf16_t* so = SB + (size_t)idxs * 16384;
#pragma unroll
                        for (int q = 0; q < 16; ++q) { const int e = 32 * et + crow(q, h);
                            so[e * 128 + 32 * dtb + r] = (bf16_t)(pk2(acc0[q], 0.f) & 0xffffu);
                            so[e * 128 + 32 * (dtb + 1) + r] = (bf16_t)(pk2(acc1[q], 0.f) & 0xffffu); }
                        { const int d = tid >> 2, q4 = tid & 3; float sum = 0.f;
#pragma unroll
                          for (int i = 0; i < 8; ++i) { const bf16x8 v = *(const LAS bf16x8*)(KsT + d * VT_PITCH + 64 * q4 + 8 * i);
#pragma unroll
                              for (int j = 0; j < 8; ++j) sum += bf2f(v[j]); }
                          sum += __shfl_xor(sum, 1); sum += __shfl_xor(sum, 2);
                          if (q4 == 0) NS[(size_t)idxs * 128 + d] = sum; }
                        if (tid == 0) GS[idxs] = T;
                        __syncthreads();
                    }
                }
            } else if (PH_ON(2) && sub == 2) {
                for (int vb = bx; vb < 256; vb += G_) {
                    if (tid < 192) {
                        const int task = vb * 192 + tid, stream = task >> 11, grp = task & 2047;
                        const int seq = stream >> 3, head = (stream >> 1) & 3, dir = stream & 1;
                        const int c_lo = seq == 0 ? 0 : (seq == 1 ? 64 : 96), nch = seq == 0 ? 64 : 32;
                        float run[8];
#pragma unroll
                        for (int e = 0; e < 8; ++e) run[e] = 0.f;
                        for (int cb = 0; cb < nch; cb += 8) {
                            u32x4 v[8]; float dg[8];
#pragma unroll
                            for (int j = 0; j < 8; ++j) { const int c = dir ? (c_lo + nch - 1 - (cb + j)) : (c_lo + cb + j); const int idxs = (c * 4 + head) * 2 + dir;
                                v[j] = *(const u32x4*)(SB + (size_t)idxs * 16384 + grp * 8); dg[j] = GS[idxs]; }
#pragma unroll
                            for (int j = 0; j < 8; ++j) { const int c = dir ? (c_lo + nch - 1 - (cb + j)) : (c_lo + cb + j); const int idxs = (c * 4 + head) * 2 + dir;
                                u32x4 o; o.x = pk2(run[0], run[1]); o.y = pk2(run[2], run[3]); o.z = pk2(run[4], run[5]); o.w = pk2(run[6], run[7]);
                                *(u32x4*)(SB + (size_t)idxs * 16384 + grp * 8) = o;
                                const float dec = __expf(dg[j]);
                                run[0] = dec * run[0] + bflo(v[j].x); run[1] = dec * run[1] + bfhi(v[j].x); run[2] = dec * run[2] + bflo(v[j].y); run[3] = dec * run[3] + bfhi(v[j].y);
                                run[4] = dec * run[4] + bflo(v[j].z); run[5] = dec * run[5] + bfhi(v[j].z); run[6] = dec * run[6] + bflo(v[j].w); run[7] = dec * run[7] + bfhi(v[j].w); }
                        }
                    } else if (tid < 204) {
                        const int task = vb * 12 + (tid - 192), stream = task >> 7, d = task & 127;
                        const int seq = stream >> 3, head = (stream >> 1) & 3, dir = stream & 1;
                        const int c_lo = seq == 0 ? 0 : (seq == 1 ? 64 : 96), nch = seq == 0 ? 64 : 32;
                        float run = 0.f;
                        for (int cb = 0; cb < nch; ++cb) { const int c = dir ? (c_lo + nch - 1 - cb) : (c_lo + cb); const int idxs = (c * 4 + head) * 2 + dir;
                            const float dn = NS[(size_t)idxs * 128 + d]; const float dec = __expf(GS[idxs]);
                            NS[(size_t)idxs * 128 + d] = run; run = dec * run + dn; }
                    }
                }
            } else if (PH_ON(3) && sub == 3) {
                LAS bf16_t* KI = (LAS bf16_t*)(lds + L_KI); LAS bf16_t* VT = (LAS bf16_t*)(lds + L_VT);
                LAS float* bt = (LAS float*)(lds + L_BT); LAS float* cs = (LAS float*)(lds + L_CS); LAS float* nst = (LAS float*)(lds + L_NST);
                const int r = lane & 31, h = lane >> 5;
                for (int item = bx; item < 512; item += G_) {
                    const int cgk = item >> 2, head = item & 3, tok0 = cgk * 256;
                    int tl = tid; asm volatile("" : "+v"(tl));
                    __syncthreads();
#pragma unroll
                    for (int i = 0; i < 8; ++i) { const int idx = tl + 512 * i, row = idx >> 4, c16 = idx & 15;
                        const bf16x8 v = *(const bf16x8*)(PROJ + (size_t)(tok0 + row) * PW + 1024 + head * 128 + 8 * c16);
                        *(LAS bf16x8*)(KI + row * KI_PITCH + 8 * c16) = v; }
#pragma unroll
                    for (int i = 0; i < 8; ++i) { const int idx = tl + 512 * i, s = idx & 255, gd = idx >> 8;
                        const bf16x8 v = *(const bf16x8*)(PROJ + (size_t)(tok0 + s) * PW + 1536 + head * 128 + 8 * gd);
#pragma unroll
                        for (int j = 0; j < 8; ++j) VT[(8 * gd + j) * VT_PITCH + s] = (bf16_t)v[j]; }
                    if (tid < 256) { const int dir = tid >> 7, d = tid & 127; nst[dir * 128 + d] = NS[(size_t)((cgk * 4 + head) * 2 + dir) * 128 + d]; }
                    gates_prepare(lds, GT, tok0, head, tid, wave, lane);
                    const int t0 = 32 * wave, tq = t0 + r;
                    bf16_t* prow = PROJ + (size_t)(tok0 + tq) * PW + head * 128;
                    bf16x8 qf[8];
#pragma unroll
                    for (int kd = 0; kd < 8; ++kd) qf[kd] = *(const bf16x8*)(prow + 512 + 16 * kd + 8 * h);
                    unsigned hp[4][8];
#pragma unroll
                    for (int et = 0; et < 4; ++et)
#pragma unroll
                        for (int q = 0; q < 8; ++q) hp[et][q] = 0u;
                    f32x16 o[4];
                    for (int dir = 0; dir < 2; ++dir) {
#pragma unroll
                        for (int et = 0; et < 4; ++et)
#pragma unroll
                            for (int q = 0; q < 16; ++q) o[et][q] = 0.f;
                        const bf16_t* cst = SB + (size_t)((cgk * 4 + head) * 2 + dir) * 16384;
#pragma unroll
                        for (int et = 0; et < 4; ++et)
#pragma unroll
                            for (int kd = 0; kd < 8; ++kd) { const bf16x8 a = *(const bf16x8*)(cst + (32 * et + r) * 128 + 16 * kd + 8 * h); o[et] = MFMA32(a, qf[kd], o[et]); if (kd == 7) asm volatile("" ::: "memory"); }
                        float nq = 0.f;
#pragma unroll
                        for (int kd = 0; kd < 8; ++kd) { const LAS f32x4* np = (const LAS f32x4*)(nst + dir * 128 + 16 * kd + 8 * h); const f32x4 n0 = np[0], n1 = np[1];
                            nq += n0[0] * bf2f(qf[kd][0]) + n0[1] * bf2f(qf[kd][1]) + n0[2] * bf2f(qf[kd][2]) + n0[3] * bf2f(qf[kd][3])
                                + n1[0] * bf2f(qf[kd][4]) + n1[1] * bf2f(qf[kd][5]) + n1[2] * bf2f(qf[kd][6]) + n1[3] * bf2f(qf[kd][7]); }
                        nq += __shfl_xor(nq, 32);
                        const float btl = bt[dir * 256 + tq];
                        const float ebt = __expf(btl);
#pragma unroll
                        for (int et = 0; et < 4; ++et)
#pragma unroll
                            for (int q = 0; q < 16; ++q) o[et][q] *= ebt;
                        float dsum = 0.f;
                        const int st_lo = dir == 0 ? 0 : wave, st_hi = dir == 0 ? wave : 7;
                        for (int st = st_lo; st <= st_hi; ++st) {
                            f32x16 x;
#pragma unroll
                            for (int q = 0; q < 16; ++q) x[q] = 0.f;
#pragma unroll
                            for (int kd = 0; kd < 8; ++kd) { const bf16x8 a = *(const LAS bf16x8*)(KI + (32 * st + r) * KI_PITCH + 16 * kd + 8 * h); x = MFMA32(a, qf[kd], x); }
#pragma unroll
                            for (int g4 = 0; g4 < 4; ++g4) { const f32x4 c4 = *(const LAS f32x4*)(cs + dir * 256 + 32 * st + 8 * g4 + 4 * h);
#pragma unroll
                                for (int e = 0; e < 4; ++e) { const int s = 32 * st + 8 * g4 + 4 * h + e; const bool valid = dir == 0 ? (s <= tq) : (s >= tq);
                                    const float wgt = __expf(btl + c4[e]); const float p = valid ? x[4 * g4 + e] * wgt : 0.f; x[4 * g4 + e] = p; dsum += p; } }
                            bf16x8 xs[2];
#pragma unroll
                            for (int ks = 0; ks < 2; ++ks) { u32x4 p; p.x = pk2(x[8 * ks], x[8 * ks + 1]); p.y = pk2(x[8 * ks + 2], x[8 * ks + 3]); p.z = pk2(x[8 * ks + 4], x[8 * ks + 5]); p.w = pk2(x[8 * ks + 6], x[8 * ks + 7]); xs[ks] = __builtin_bit_cast(bf16x8, p); }
#pragma unroll
                            for (int et = 0; et < 4; ++et)
#pragma unroll
                                for (int ks = 0; ks < 2; ++ks) { const LAS bf16_t* vp = VT + (32 * et + r) * VT_PITCH + 32 * st + 16 * ks + 4 * h;
                                    const s16x4 lo = *(const LAS s16x4*)vp, hi = *(const LAS s16x4*)(vp + 8);
                                    const bf16x8 a = __builtin_shufflevector(lo, hi, 0, 1, 2, 3, 4, 5, 6, 7); o[et] = MFMA32(a, xs[ks], o[et]); }
                        }
                        dsum += __shfl_xor(dsum, 32);
                        const float den = dsum + ebt * nq;
                        const float inv = 1.f / fmaxf(fabsf(den), 1.f);
                        if (dir == 0) {
#pragma unroll
                            for (int et = 0; et < 4; ++et)
#pragma unroll
                                for (int q = 0; q < 8; ++q) hp[et][q] = pk2(o[et][2 * q] * inv, o[et][2 * q + 1] * inv);
                        } else {
#pragma unroll
                            for (int et = 0; et < 4; ++et)
#pragma unroll
                                for (int q = 0; q < 8; ++q) { o[et][2 * q] = o[et][2 * q] * inv + bflo(hp[et][q]); o[et][2 * q + 1] = o[et][2 * q + 1] * inv + bfhi(hp[et][q]); }
                        }
                    }
                    float s1 = 0.f;
#pragma unroll
                    for (int et = 0; et < 4; ++et)
#pragma unroll
                        for (int q = 0; q < 16; ++q) s1 += o[et][q];
                    s1 += __shfl_xor(s1, 32);
                    const float mean = s1 * (1.f / 128.f);
                    float s2 = 0.f;
#pragma unroll
                    for (int et = 0; et < 4; ++et)
#pragma unroll
                        for (int q = 0; q < 16; ++q) { const float dd = o[et][q] - mean; s2 += dd * dd; }
                    s2 += __shfl_xor(s2, 32);
                    const float rstd = rsqrtf(s2 * (1.f / 128.f) + LN_EPS);
                    const float* mw = mh_norm_w + l * 512 + head * 128;
#pragma unroll
                    for (int et = 0; et < 4; ++et)
#pragma unroll
                        for (int g4 = 0; g4 < 4; ++g4) { const int e0 = 32 * et + 8 * g4 + 4 * h;
                            const u32x2 og = *(const u32x2*)(prow + e0); const f32x4 w4 = *(const f32x4*)(mw + e0);
                            const float o0 = bflo(og.x), o1 = bfhi(og.x), o2 = bflo(og.y), o3 = bfhi(og.y);
                            const float y0 = (o[et][4 * g4 + 0] - mean) * rstd * w4[0] / (1.f + __expf(-o0));
                            const float y1 = (o[et][4 * g4 + 1] - mean) * rstd * w4[1] / (1.f + __expf(-o1));
                            const float y2 = (o[et][4 * g4 + 2] - mean) * rstd * w4[2] / (1.f + __expf(-o2));
                            const float y3 = (o[et][4 * g4 + 3] - mean) * rstd * w4[3] / (1.f + __expf(-o3));
                            u32x2 w; w.x = pk2(y0, y1); w.y = pk2(y2, y3); *(u32x2*)(prow + e0) = w; if (g4 == 3) asm volatile("" ::: "memory"); }
                }
                __syncthreads();
            } else if (PH_ON(5) && sub == 5) {
                const float* cw = conv_w + l * 1536;
                for (int task = bx * NTHREADS + tid; task < MTOK * 64; task += G_ * NTHREADS) {
                    const int m = task >> 6, c8 = task & 63;
                    const bool hp = !(m == 0 || m == 16384 || m == 24576), hn = !(m == 16383 || m == 24575 || m == 32767);
                    bf16_t* row = PROJ + (size_t)m * PW + 8 * c8;
                    const bf16x8 cb = *(const bf16x8*)(row + 512), c0 = *(const bf16x8*)(row + 1024), h0 = *(const bf16x8*)(row + 1536);
                    bf16x8 cm = c0, hm = h0, cp = c0, hpv = h0;
                    if (hp) { cm = *(const bf16x8*)(row - PW + 1024); hm = *(const bf16x8*)(row - PW + 1536); }
                    if (hn) { cp = *(const bf16x8*)(row + PW + 1024); hpv = *(const bf16x8*)(row + PW + 1536); }
                    float y[8];
#pragma unroll
                    for (int j = 0; j < 8; ++j) { const float w0 = cw[8 * c8 + j], w1 = cw[512 + 8 * c8 + j], w2 = cw[1024 + 8 * c8 + j];
                        const float um = hp ? bf2f(cm[j]) * bf2f(hm[j]) : 0.f, u0 = bf2f(c0[j]) * bf2f(h0[j]), up = hn ? bf2f(cp[j]) * bf2f(hpv[j]) : 0.f;
                        y[j] = bf2f(cb[j]) * (w0 * um + w1 * u0 + w2 * up); }
                    u32x4 o; o.x = pk2(y[0], y[1]); o.y = pk2(y[2], y[3]); o.z = pk2(y[4], y[5]); o.w = pk2(y[6], y[7]);
                    *(u32x4*)(row + 512) = o;
                }
            } else if (PH_ON(6) && (sub == 6 || sub == 9 || sub == 11)) {
                const bool isC = sub == 6; const int hf = sub == 11 ? 1 : 0;
                const bf16_t* Wout_t = WL_PTR(W_IN_B); const bf16_t* Wff2_t = WL_PTR(W_IN_B + W_OUT_B + W_FF1_B);
                pg8::Gemm g{isC ? PROJ : HID, isC ? Wout_t : Wff2_t, isC ? MTOK : MHALF, D, isC ? D : FF, isC ? PW : FF};
                pg8::StaticOrder S; S.init(g.M, D, G_, bx);
                float* xo = X + (isC ? (size_t)0 : (size_t)hf * MHALF * D);
                pg8::EpiRes E{xo, xo, D, ALPHA};
                pg8::gemm_phase<pg8::EpiRes, true>(lds, g, S, E, tid);
            } else if (PH_ON(7) && (sub == 7 || sub == 12)) {
                const float* gg = (sub == 7 ? ln1_g : ln2_g) + l * D; const float* bb = (sub == 7 ? ln1_b : ln2_b) + l * D;
                f32x4 gv[4], bv[4];
#pragma unroll
                for (int j = 0; j < 4; ++j) { gv[j] = ((const f32x4*)gg)[lane + 64 * j]; bv[j] = ((const f32x4*)bb)[lane + 64 * j]; }
                for (int m = gw; m < MTOK; m += NGW) {
                    f32x4* xr = (f32x4*)(X + (size_t)m * D) + lane; u32x2* o2 = (u32x2*)(XB + (size_t)m * D) + lane;
                    f32x4 v[4]; float s = 0.f;
#pragma unroll
                    for (int j = 0; j < 4; ++j) { v[j] = xr[64 * j]; s += (v[j][0] + v[j][1]) + (v[j][2] + v[j][3]); }
                    const float mean = wave_sum(s) * (1.f / D); float s2 = 0.f;
#pragma unroll
                    for (int j = 0; j < 4; ++j) { v[j] = v[j] - mean; s2 += (v[j][0] * v[j][0] + v[j][1] * v[j][1]) + (v[j][2] * v[j][2] + v[j][3] * v[j][3]); }
                    const float rstd = rsqrtf(wave_sum(s2) * (1.f / D) + LN_EPS);
#pragma unroll
                    for (int j = 0; j < 4; ++j) { const f32x4 y = v[j] * rstd * gv[j] + bv[j]; xr[64 * j] = y; u32x2 w; w.x = pk2(y[0], y[1]); w.y = pk2(y[2], y[3]); o2[64 * j] = w; }
                }
            } else if (PH_ON(8) && (sub == 8 || sub == 10)) {
                const int hf = sub == 10 ? 1 : 0;
                const bf16_t* Wff1_t = WL_PTR(W_IN_B + W_OUT_B);
                pg8::Gemm g{XB + (size_t)hf * MHALF * D, Wff1_t, MHALF, FF, D, D};
                pg8::StaticOrder S; S.init(MHALF, FF, G_, bx);
                pg8::EpiBf16<2> E{HID, FF};
                pg8::gemm_phase<pg8::EpiBf16<2>, true>(lds, g, S, E, tid);
            }
        }
        if (ph + 1 < args.ph_hi) grid.sync();
    }
}

extern "C" void kernel_launch(void* const* d_in, const int* in_sizes, int n_in, void* d_out, int out_size, void* d_ws, size_t ws_size, hipStream_t stream) {
    static int grid = 0;
    if (grid == 0) {
        if (n_in != 13 || out_size != MTOK * D || ws_size < WS_END) { fprintf(stderr, "kernel_launch: unexpected shapes (n_in %d out %d ws %zu need %zu)\n", n_in, out_size, ws_size, (size_t)WS_END); grid = -1; return; }
        int dev = 0, cus = 0, per_cu = 0;
        hipGetDevice(&dev); hipDeviceGetAttribute(&cus, hipDeviceAttributeMultiprocessorCount, dev);
        hipFuncSetAttribute((const void*)mk_fwd, hipFuncAttributeMaxDynamicSharedMemorySize, LDS_BYTES);
        hipOccupancyMaxActiveBlocksPerMultiprocessor(&per_cu, (const void*)mk_fwd, NTHREADS, LDS_BYTES);
        (void)hipGetLastError();
        if (per_cu < 1) per_cu = 1;
        grid = cus * 1;
        if (grid > 256) grid = 256;
    }
    if (grid < 0) return;
    Args a{};
    for (int i = 0; i < 13; ++i) a.in[i] = (const float*)d_in[i];
    a.out = (float*)d_out; a.ws = (unsigned char*)d_ws;
#if MK_COOP
    a.ph_lo = 0; a.ph_hi = NPHASES;
    void* kargs[] = {&a};
    hipError_t e = hipLaunchCooperativeKernel((const void*)mk_fwd, dim3(grid), dim3(NTHREADS), kargs, LDS_BYTES, stream);
    if (e != hipSuccess) fprintf(stderr, "cooperative launch failed: %s (grid %d)\n", hipGetErrorString(e), grid);
#else
    for (int ph = 0; ph < NPHASES; ++ph) { a.ph_lo = ph; a.ph_hi = ph + 1; hipLaunchKernelGGL(mk_fwd, dim3(grid), dim3(NTHREADS), LDS_BYTES, stream, a); }
#endif
}
```
